# Optimizing an MI355X kernel written in HIP

```python
import math
import jax
import jax.numpy as jnp
from jax import lax
import numpy as np


D_MODEL = 1024
BATCH = 2
SEQ = 16384
DEPTH = 4
DEC_BATCH = 16
DEC_SEQ = 4096
PAST_LEN = 128

N_MIXERS = 2
N_A_LAYERS = (DEPTH + 1) // 2
N_B_LAYERS = DEPTH // 2
HEAD_DIM = 64
N_HEADS = D_MODEL // HEAD_DIM
DIL_GROUPS = ((128, 1), (512, 4), (2048, 16))
N_GROUPS = len(DIL_GROUPS)
GROUP_WIDTH = N_HEADS * HEAD_DIM
QKV_WIDTH = 3 * N_GROUPS * GROUP_WIDTH
Q_BLOCK = 64
N_BUCKETS = 32
MAX_DISTANCE = 1024
N_FGROUPS = 4
FGROUP = D_MODEL // N_FGROUPS
D_FF = -((-8 * D_MODEL) // (3 * 256)) * 256
ALPHA = (2 * DEPTH) ** 0.25
BETA = (8 * DEPTH) ** -0.25
LN_EPS = 1e-5
NEG_INF = -1e30

kernel_name = 'hybrid_dilated_attn_fnet_encoder'


def layer_norm(x, g, b):
    xf = x.astype(jnp.float32)
    mu = jnp.mean(xf, axis=-1, keepdims=True)
    var = jnp.mean(jnp.square(xf - mu), axis=-1, keepdims=True)
    return ((xf - mu) * lax.rsqrt(var + LN_EPS) * g.astype(jnp.float32) + b.astype(jnp.float32)).astype(x.dtype)


def rel_bucket(rel):
    nb = N_BUCKETS // 2
    max_exact = nb // 2
    ret = jnp.where(rel > 0, nb, 0)
    n = jnp.abs(rel)
    nf = jnp.maximum(n, 1).astype(jnp.float32)
    large = max_exact + (jnp.log(nf / max_exact) / math.log(MAX_DISTANCE / max_exact) * (nb - max_exact)).astype(jnp.int32)
    large = jnp.minimum(large, nb - 1)
    return ret + jnp.where(n < max_exact, n, large)


def dilated_attention(q, k, v, bias_tbl, window, dilation):
    S, H, Dh = q.shape
    r = dilation
    half = window // (2 * r)
    kw = Q_BLOCK + 2 * half
    unit = r * Q_BLOCK
    s_pad = -(-S // unit) * unit
    L = s_pad // r
    nblk = L // Q_BLOCK

    def to_sub(t):
        t = jnp.pad(t, ((0, s_pad - S), (0, 0), (0, 0)))
        return t.reshape(L, r, H, Dh).transpose(1, 0, 2, 3)

    qb = to_sub(q).reshape(r, nblk, Q_BLOCK, H, Dh)
    kidx = jnp.arange(nblk)[:, None] * Q_BLOCK + jnp.arange(kw)[None, :]
    kb = jnp.pad(to_sub(k), ((0, 0), (half, half), (0, 0), (0, 0)))[:, kidx]
    vb = jnp.pad(to_sub(v), ((0, 0), (half, half), (0, 0), (0, 0)))[:, kidx]

    j = kidx - half
    pos = j[None] * r + jnp.arange(r)[:, None, None]
    key_ok = (j >= 0)[None] & (pos < S)
    rel = jnp.arange(kw)[None, :] - half - jnp.arange(Q_BLOCK)[:, None]
    band = jnp.abs(rel) <= half
    bias = jnp.moveaxis(bias_tbl[rel_bucket(rel * r)].astype(jnp.float32), -1, 0)

    s = jnp.einsum('rnqhd,rnkhd->rnhqk', qb, kb, preferred_element_type=jnp.float32) * (HEAD_DIM ** -0.5) + bias
    ok = band[None, None, None] & key_ok[:, :, None, None, :]
    s = jnp.where(ok, s, NEG_INF)
    m = jnp.max(s, axis=-1, keepdims=True)
    p = jnp.exp(s - m)
    den = jnp.sum(p, axis=-1, keepdims=True)
    o = jnp.einsum('rnhqk,rnkhd->rnqhd', p, vb.astype(jnp.float32)) / den.transpose(0, 1, 3, 2, 4)
    lse = (m + jnp.log(den))[..., 0].transpose(0, 1, 3, 2)

    o = o.reshape(r, L, H, Dh).transpose(1, 0, 2, 3).reshape(s_pad, H, Dh)[:S]
    lse = lse.reshape(r, L, H).transpose(1, 0, 2).reshape(s_pad, H)[:S]
    return o, lse


def mixer_a_seq(x, w_qkv, w_o, rel_bias):
    S = x.shape[0]
    qkv = (x @ w_qkv).reshape(S, 3, N_GROUPS, N_HEADS, HEAD_DIM)
    outs = []
    lses = []
    for g, (window, dil) in enumerate(DIL_GROUPS):
        o, l = dilated_attention(qkv[:, 0, g], qkv[:, 1, g], qkv[:, 2, g],
                                 rel_bias[:, g * N_HEADS:(g + 1) * N_HEADS], window, dil)
        outs.append(o)
        lses.append(l)
    wts = jax.nn.softmax(jnp.stack(lses), axis=0)
    o = jnp.sum(wts[..., None] * jnp.stack(outs), axis=0)
    return o.reshape(S, GROUP_WIDTH).astype(x.dtype) @ w_o


def mixer_a(x, w_qkv, w_o, rel_bias):
    return lax.map(lambda xs: mixer_a_seq(xs, w_qkv, w_o, rel_bias), x)


def mixer_b(x, w_o, b_o):
    B, S, D = x.shape
    xg = x.astype(jnp.float32).reshape(B, S, N_FGROUPS, FGROUP)
    f = jnp.fft.fft2(xg, axes=(1, 3), norm='ortho').real
    return f.reshape(B, S, D).astype(x.dtype) @ w_o + b_o


def swiglu(x, w_gate, w_up, w_down):
    return (jax.nn.silu(x @ w_gate) * (x @ w_up)) @ w_down


def encoder_trunk(x, rel_bias, w_qkv_a, w_o_a, w_o_b, b_o_b, w_gate, w_up, w_down, ln1_g, ln1_b, ln2_g, ln2_b):
    for i in range(DEPTH):
        li = i // N_MIXERS
        if i % N_MIXERS == 0:
            h = mixer_a(x, w_qkv_a[li], w_o_a[li], rel_bias)
        else:
            h = mixer_b(x, w_o_b[li], b_o_b[li])
        x = layer_norm(ALPHA * x + h, ln1_g[i], ln1_b[i])
        x = layer_norm(ALPHA * x + swiglu(x, w_gate[i], w_up[i], w_down[i]), ln2_g[i], ln2_b[i])
    return x


def setup_inputs(seed: int = 0) -> dict:
    key = jax.random.key(seed)
    ks = jax.random.split(key, 15)

    def nrm(k, shape, scale):
        return jax.random.normal(k, shape, jnp.float32) * scale

    return {
        'x_prompt': nrm(ks[0], (BATCH, SEQ, D_MODEL), 1.0),
        'x_sample': nrm(ks[1], (DEC_BATCH, DEC_SEQ, D_MODEL), 1.0),
        'rel_bias': nrm(ks[2], (N_BUCKETS, N_GROUPS * N_HEADS), 0.5),
        'w_qkv_a': nrm(ks[3], (N_A_LAYERS, D_MODEL, QKV_WIDTH), D_MODEL ** -0.5),
        'w_o_a': nrm(ks[4], (N_A_LAYERS, GROUP_WIDTH, D_MODEL), BETA * GROUP_WIDTH ** -0.5),
        'w_o_b': nrm(ks[5], (N_B_LAYERS, D_MODEL, D_MODEL), BETA * D_MODEL ** -0.5),
        'b_o_b': nrm(ks[6], (N_B_LAYERS, D_MODEL), 0.02),
        'w_gate': nrm(ks[7], (DEPTH, D_MODEL, D_FF), D_MODEL ** -0.5),
        'w_up': nrm(ks[8], (DEPTH, D_MODEL, D_FF), D_MODEL ** -0.5),
        'w_down': nrm(ks[9], (DEPTH, D_FF, D_MODEL), BETA * D_FF ** -0.5),
        'ln1_g': 1.0 + nrm(ks[10], (DEPTH, D_MODEL), 0.02),
        'ln1_b': nrm(ks[11], (DEPTH, D_MODEL), 0.02),
        'ln2_g': 1.0 + nrm(ks[12], (DEPTH, D_MODEL), 0.02),
        'ln2_b': nrm(ks[13], (DEPTH, D_MODEL), 0.02),
    }


def reference(x_prompt, x_sample, rel_bias, w_qkv_a, w_o_a, w_o_b, b_o_b, w_gate, w_up, w_down, ln1_g, ln1_b, ln2_g, ln2_b):
    y_prompt = encoder_trunk(x_prompt, rel_bias, w_qkv_a, w_o_a, w_o_b, b_o_b, w_gate, w_up, w_down, ln1_g, ln1_b, ln2_g, ln2_b)
    y_sample = encoder_trunk(x_sample, rel_bias, w_qkv_a, w_o_a, w_o_b, b_o_b, w_gate, w_up, w_down, ln1_g, ln1_b, ln2_g, ln2_b)
    return (y_prompt, y_sample)
```

```cpp
#include <hip/hip_runtime.h>
#include <hip/hip_cooperative_groups.h>
#include <cstdio>
#include <cstdint>
namespace cg = cooperative_groups;

#define LAS __attribute__((address_space(3)))
typedef unsigned short bf16_t;
typedef short bf16x8 __attribute__((ext_vector_type(8)));
typedef short s16x4 __attribute__((ext_vector_type(4)));
typedef float f32x4 __attribute__((ext_vector_type(4)));
typedef float f32x16 __attribute__((ext_vector_type(16)));
typedef float f32x2 __attribute__((ext_vector_type(2)));
typedef unsigned u32x4 __attribute__((ext_vector_type(4)));
typedef unsigned u32x2 __attribute__((ext_vector_type(2)));

constexpr int DM = 1024, DFF = 2816, NQKV = 9216, NGU = 5632, DEPTH = 4;
constexpr int CH = 16384;
constexpr int NCHUNK = 6;
constexpr float ALPHA = 1.681792830507429f;
constexpr float LN_EPS = 1e-5f;

constexpr size_t MiB = 1u << 20;
constexpr size_t WS_TW = 1 * MiB;
constexpr size_t WS_BIAS = WS_TW + 131072;
constexpr size_t WS_DFT128 = WS_BIAS + 32768;
constexpr size_t WS_DFT64 = WS_DFT128 + 65536;
constexpr size_t WS_WCH = 2 * MiB;
constexpr size_t WS_WQKV = 3 * MiB;
constexpr size_t WS_WOA = WS_WQKV + 36 * MiB;
constexpr size_t WS_WOB = WS_WOA + 4 * MiB;
constexpr size_t WS_WGU = WS_WOB + 4 * MiB;
constexpr size_t WS_WD = WS_WGU + 44 * MiB;
constexpr size_t WS_XB = WS_WD + 22 * MiB;
constexpr size_t WS_O = WS_XB + 32 * MiB;
constexpr size_t WS_BIG = WS_O + 32 * MiB;
constexpr size_t WS_END = WS_BIG + 288 * MiB;
constexpr size_t BIG_Z = 0, BIG_G = 64 * MiB, BIG_ACT = 128 * MiB;

constexpr int DBG_SKIP_ATTN = 0, DBG_SKIP_DFT = 0;
constexpr int LDS_MISC = 131072 + 8192;
constexpr int LDS_BYTES = 147456;

__device__ __forceinline__ unsigned f2bf(float f) { unsigned u = __builtin_bit_cast(unsigned, f); return (u + 0x7fffu + ((u >> 16) & 1u)) >> 16; }
__device__ __forceinline__ unsigned pk2(float lo, float hi) { return f2bf(lo) | (f2bf(hi) << 16); }
typedef __bf16 hwbf16x2 __attribute__((ext_vector_type(2)));
__device__ __forceinline__ unsigned cvt_pk_bf16(float lo, float hi) { const f32x2 v = {lo, hi}; return __builtin_bit_cast(unsigned, __builtin_convertvector(v, hwbf16x2)); }
__device__ __forceinline__ float bf2f(unsigned short b) { return __builtin_bit_cast(float, ((unsigned)b) << 16); }
#define LDS_WAIT() asm volatile("s_waitcnt lgkmcnt(0)" ::: "memory")
__device__ __forceinline__ int opaque_tid() { int t = threadIdx.x; asm volatile("" : "+v"(t)); return t; }

namespace pg8 {
constexpr int BM = 256, BK = 64, HALF = 128, HTB = HALF * BK * 2, STAGE_BYTES = 8 * HTB, NXCD = 8, WGM = 8;
__host__ __device__ __forceinline__ int lds_byte(int r, int c) { const int st = (r >> 4) * 2 + (c >> 5), rr = r & 15, cc = c & 31, ob = rr * 64 + cc * 2; return st * 1024 + (ob ^ (((ob >> 9) & 1) << 5)); }
__host__ __device__ __forceinline__ void stage_rc(int b, int& R, int& C) { const int st = b / 1024, sb = b % 1024, swz = sb ^ (((sb >> 9) & 1) << 5); R = (st >> 1) * 16 + swz / 64; C = (st & 1) * 32 + (swz % 64) / 2; }
__host__ __device__ __forceinline__ int perm32(int rho) { const int n = rho >> 4, i = rho & 15; return 8 * (i >> 2) + 4 * n + (i & 3); }

struct Unit { int pm, pn; };
struct Gemm { const bf16_t* A; const bf16_t* Bt; int M, N, K, lda, ldb, agrp_shift, agrp_elems; };

struct StaticOrder {
    int nM, nN, nwg, G, c;
    __device__ void init(int M, int N, int G_, int c_) { nM = M / BM; nN = N / BM; nwg = nM * nN; G = G_; c = c_; }
    __device__ bool next(int i, Unit& u) const {
        const long L = (long)i * G + c; if (L >= nwg) return false;
        int wgid = (int)L; { const int q = nwg / NXCD, r = nwg % NXCD, xcd = wgid % NXCD, off = wgid / NXCD; wgid = (xcd < r ? xcd * (q + 1) : r * (q + 1) + (xcd - r) * q) + off; }
        const int nig = WGM * nN, gid = wgid / nig, fm = gid * WGM, gsz = (nM - fm) < WGM ? (nM - fm) : WGM;
        u.pm = fm + ((wgid % nig) % gsz); u.pn = (wgid % nig) / gsz; return true;
    }
};

struct EpiBf16 {
    static constexpr bool PERM = true;
    bf16_t* O; int ldc;
    __device__ __forceinline__ void operator()(const f32x4 (&acc)[2][2][4][2], const Unit& u, int wr, int wc, int fr, int fq) const {
        const int row0 = u.pm * BM + wr * 64 + fr; const int col0 = u.pn * BM + wc * 32 + 8 * fq;
#pragma unroll
        for (int ai = 0; ai < 2; ++ai)
#pragma unroll
            for (int m = 0; m < 4; ++m) { bf16_t* rowp = O + (size_t)(row0 + ai * HALF + m * 16) * ldc + col0;
#pragma unroll
                for (int bj = 0; bj < 2; ++bj) { const f32x4 v0 = acc[ai][bj][m][0], v1 = acc[ai][bj][m][1];
                    u32x4 w; w.x = cvt_pk_bf16(v0[0], v0[1]); w.y = cvt_pk_bf16(v0[2], v0[3]); w.z = cvt_pk_bf16(v1[0], v1[1]); w.w = cvt_pk_bf16(v1[2], v1[3]);
                    *(u32x4*)(rowp + bj * HALF) = w; } }
    }
};
struct EpiGU {
    static constexpr bool PERM = true;
    bf16_t* O;
    __device__ __forceinline__ void operator()(const f32x4 (&acc)[2][2][4][2], const Unit& u, int wr, int wc, int fr, int fq) const {
        const int row0 = u.pm * BM + wr * 64 + fr; const int col0 = u.pn * HALF + wc * 32 + 8 * fq;
#pragma unroll
        for (int ai = 0; ai < 2; ++ai)
#pragma unroll
            for (int m = 0; m < 4; ++m) { bf16_t* rowp = O + (size_t)(row0 + ai * HALF + m * 16) * DFF + col0;
                float a[8];
#pragma unroll
                for (int n = 0; n < 2; ++n)
#pragma unroll
                    for (int j = 0; j < 4; ++j) { const float g = acc[ai][0][m][n][j], uu = acc[ai][1][m][n][j]; a[n * 4 + j] = g * __builtin_amdgcn_rcpf(1.0f + __expf(-g)) * uu; }
                u32x4 w; w.x = cvt_pk_bf16(a[0], a[1]); w.y = cvt_pk_bf16(a[2], a[3]); w.z = cvt_pk_bf16(a[4], a[5]); w.w = cvt_pk_bf16(a[6], a[7]);
                *(u32x4*)rowp = w; }
    }
};
struct EpiRes {
    static constexpr bool PERM = false;
    const float* res; float* out; const float* bias;
    __device__ __forceinline__ void operator()(const f32x4 (&acc)[2][2][4][2], const Unit& u, int wr, int wc, int fr, int fq) const {
        const int row0 = u.pm * BM + wr * 64 + fr, col0 = u.pn * BM + wc * 32 + 4 * fq;
        f32x4 bv[2][2];
#pragma unroll
        for (int bj = 0; bj < 2; ++bj)
#pragma unroll
            for (int n = 0; n < 2; ++n) bv[bj][n] = bias ? *(const f32x4*)(bias + col0 + bj * HALF + n * 16) : (f32x4){0.f, 0.f, 0.f, 0.f};
#pragma unroll
        for (int ai = 0; ai < 2; ++ai)
#pragma unroll
            for (int m = 0; m < 4; ++m) { const size_t off = (size_t)(row0 + ai * HALF + m * 16) * DM + col0;
#pragma unroll
                for (int bj = 0; bj < 2; ++bj)
#pragma unroll
                    for (int n = 0; n < 2; ++n) { const f32x4 r = *(const f32x4*)(res + off + bj * HALF + n * 16);
                        *(f32x4*)(out + off + bj * HALF + n * 16) = r * ALPHA + acc[ai][bj][m][n] + bv[bj][n]; } asm volatile("" ::: "memory"); }
    }
};

template <class Epi>
__device__ __forceinline__ void gemm_phase(LAS unsigned char* lds, const Gemm g, const StaticOrder& S, const Epi& E) {
    const int tid = opaque_tid(), wid = __builtin_amdgcn_readfirstlane(tid >> 6), lane = tid & 63, wr = wid >> 2, wc = wid & 3, fr = lane & 15, fq = lane >> 4;
    const int K = g.K, nt = K / BK;
    unsigned voffA[2], voffB[2];
#pragma unroll
    for (int i = 0; i < 2; ++i) { int R, C; stage_rc(tid * 16 + i * 8192, R, C); const int Rb = Epi::PERM ? ((R & ~31) + perm32(R & 31)) : R;
        voffA[i] = (unsigned)(R * g.lda + C) * 2u; voffB[i] = (unsigned)(Rb * g.ldb + C) * 2u; }
    const size_t kstep = (size_t)(BK * 2);
    const size_t hsA = (size_t)HALF * g.lda * 2, hsB = (size_t)HALF * g.ldb * 2;
    const size_t tsA = 2 * hsA, tsB = 2 * hsB;
    const unsigned ldsw = (unsigned)wid * 1024u;
    const int aoff = lds_byte(wr * 64 + fr, fq * 8), boff = lds_byte(wc * 32 + fr, fq * 8);
#define PG8_SA(b, h) (((b) * 2 + (h)) * HTB)
#define PG8_SB(b, h) ((4 + (b) * 2 + (h)) * HTB)
#define PG8_STAGE(bufoff, gbase, voff) do { _Pragma("unroll") for (int _i = 0; _i < 2; ++_i) \
        __builtin_amdgcn_global_load_lds((const unsigned*)((const char*)(gbase) + (voff)[_i]), (LAS unsigned*)(lds + (bufoff) + ldsw + _i * 8192), 16, 0, 0); } while (0)
#define PG8_LDA(dst, b, h) do { _Pragma("unroll") for (int m = 0; m < 4; ++m) _Pragma("unroll") for (int k = 0; k < 2; ++k) dst[m][k] = *(const LAS bf16x8*)(lds + PG8_SA(b, h) + aoff + m * 2048 + k * 1024); } while (0)
#define PG8_LDB(dst, b, h) do { _Pragma("unroll") for (int n = 0; n < 2; ++n) _Pragma("unroll") for (int k = 0; k < 2; ++k) dst[n][k] = *(const LAS bf16x8*)(lds + PG8_SB(b, h) + boff + n * 2048 + k * 1024); } while (0)
#define PG8_MMA(ai, bj, At, Bt) do { __builtin_amdgcn_s_setprio(1); _Pragma("unroll") for (int m = 0; m < 4; ++m) _Pragma("unroll") for (int n = 0; n < 2; ++n) _Pragma("unroll") for (int k = 0; k < 2; ++k) \
        acc[ai][bj][m][n] = __builtin_amdgcn_mfma_f32_16x16x32_bf16(Bt[n][k], At[m][k], acc[ai][bj][m][n], 0, 0, 0); __builtin_amdgcn_s_setprio(0); } while (0)
#define PG8_WAIT_V(n) asm volatile("s_waitcnt vmcnt(" #n ")" ::: "memory")
#define PG8_WAIT_L(n) asm volatile("s_waitcnt lgkmcnt(" #n ")" ::: "memory")
#define PG8_BAR __builtin_amdgcn_s_barrier()
#define PG8_SCHED __builtin_amdgcn_sched_barrier(0)
    Unit cur, nxt; int ui = 0;
    if (!S.next(0, cur)) return;
    f32x4 acc[2][2][4][2];
#pragma unroll
    for (int a = 0; a < 2; ++a)
#pragma unroll
        for (int b = 0; b < 2; ++b)
#pragma unroll
            for (int m = 0; m < 4; ++m)
#pragma unroll
                for (int n = 0; n < 2; ++n) acc[a][b][m][n] = (f32x4){0.f, 0.f, 0.f, 0.f};
    bf16x8 At[4][2], B0[2][2], B1[2][2];
    const char* cA = (const char*)g.A + (size_t)cur.pm * tsA + (size_t)((cur.pn >> g.agrp_shift) * g.agrp_elems) * 2; const char* cB = (const char*)g.Bt + (size_t)cur.pn * tsB;
    PG8_STAGE(PG8_SB(0, 0), cB, voffB); PG8_STAGE(PG8_SA(0, 0), cA, voffA); PG8_STAGE(PG8_SB(0, 1), cB + hsB, voffB); PG8_STAGE(PG8_SA(0, 1), cA + hsA, voffA);
    if (wr == 1) PG8_BAR;
    PG8_WAIT_V(4); PG8_BAR;
    PG8_STAGE(PG8_SB(1, 0), cB + kstep, voffB); PG8_STAGE(PG8_SA(1, 0), cA + kstep, voffA); PG8_STAGE(PG8_SB(1, 1), cB + hsB + kstep, voffB);
    PG8_WAIT_V(6); PG8_BAR;
    for (;;) {
        const bool has_next = S.next(ui + 1, nxt);
        const char* nA = has_next ? (const char*)g.A + (size_t)nxt.pm * tsA + (size_t)((nxt.pn >> g.agrp_shift) * g.agrp_elems) * 2 : cA; const char* nB = has_next ? (const char*)g.Bt + (size_t)nxt.pn * tsB : cB;
        for (int t = 0; t < nt; t += 2) {
            const bool last = (t == nt - 2);
            const char* a1 = cA + (size_t)(t + 1) * kstep;
            const char* a2 = last ? nA : cA + (size_t)(t + 2) * kstep; const char* b2 = last ? nB : cB + (size_t)(t + 2) * kstep;
            const char* a3 = a2 + kstep; const char* b3 = b2 + kstep;
            PG8_LDB(B0, 0, 0); PG8_SCHED; PG8_LDA(At, 0, 0); PG8_STAGE(PG8_SA(1, 1), a1 + hsA, voffA);
            PG8_WAIT_L(8); PG8_BAR; PG8_WAIT_L(0); PG8_MMA(0, 0, At, B0); PG8_BAR; PG8_SCHED;
            PG8_LDB(B1, 0, 1); PG8_STAGE(PG8_SB(0, 0), b2, voffB);
            PG8_BAR; PG8_WAIT_L(0); PG8_MMA(0, 1, At, B1); PG8_BAR;
            PG8_LDA(At, 0, 1); PG8_STAGE(PG8_SA(0, 0), a2, voffA);
            PG8_BAR; PG8_WAIT_L(0); PG8_MMA(1, 0, At, B0); PG8_BAR; PG8_SCHED;
            PG8_STAGE(PG8_SB(0, 1), b2 + hsB, voffB);
            PG8_WAIT_V(6); PG8_BAR; PG8_MMA(1, 1, At, B1); PG8_BAR;
            PG8_LDB(B0, 1, 0); PG8_SCHED; PG8_LDA(At, 1, 0); PG8_STAGE(PG8_SA(0, 1), a2 + hsA, voffA);
            PG8_WAIT_L(8); PG8_BAR; PG8_WAIT_L(0); PG8_MMA(0, 0, At, B0); PG8_BAR; PG8_SCHED;
            PG8_LDB(B1, 1, 1); PG8_STAGE(PG8_SB(1, 0), b3, voffB);
            PG8_BAR; PG8_WAIT_L(0); PG8_MMA(0, 1, At, B1); PG8_BAR;
            PG8_LDA(At, 1, 1); PG8_STAGE(PG8_SA(1, 0), a3, voffA);
            PG8_BAR; PG8_WAIT_L(0); PG8_MMA(1, 0, At, B0); PG8_BAR; PG8_SCHED;
            PG8_STAGE(PG8_SB(1, 1), b3 + hsB, voffB);
            PG8_WAIT_V(6); PG8_BAR; PG8_MMA(1, 1, At, B1); PG8_BAR;
        }
        E(acc, cur, wr, wc, fr, fq);
        if (!has_next) break;
#pragma unroll
        for (int a = 0; a < 2; ++a)
#pragma unroll
            for (int b = 0; b < 2; ++b)
#pragma unroll
                for (int m = 0; m < 4; ++m)
#pragma unroll
                    for (int n = 0; n < 2; ++n) acc[a][b][m][n] = (f32x4){0.f, 0.f, 0.f, 0.f};
        cur = nxt; cA = nA; cB = nB; ++ui;
    }
    PG8_WAIT_V(0);
    if (wr == 0) PG8_BAR;
    PG8_BAR;
#undef PG8_SA
#undef PG8_SB
#undef PG8_STAGE
#undef PG8_LDA
#undef PG8_LDB
#undef PG8_MMA
#undef PG8_WAIT_V
#undef PG8_WAIT_L
#undef PG8_BAR
#undef PG8_SCHED
}
}

__device__ __forceinline__ void transpose_item(const float* W, int K, int N, bf16_t* WT, int k0, int n0, int dst_row0, float scale, LAS float* scr, int lane) {
#pragma unroll 8
    for (int i = 0; i < 32; ++i) { const int kk = 2 * i + (lane >> 5); scr[kk * 33 + (lane & 31)] = W[(size_t)(k0 + kk) * N + n0 + (lane & 31)] * scale; }
    LDS_WAIT(); asm volatile("" ::: "memory");
    const int c = lane & 7;
#pragma unroll
    for (int j = 0; j < 4; ++j) { const int n = (lane >> 3) + 8 * j; const LAS float* s = scr + (8 * c) * 33 + n;
        u32x4 o; o.x = pk2(s[0 * 33], s[1 * 33]); o.y = pk2(s[2 * 33], s[3 * 33]); o.z = pk2(s[4 * 33], s[5 * 33]); o.w = pk2(s[6 * 33], s[7 * 33]);
        *(u32x4*)(WT + (size_t)(dst_row0 + n) * K + k0 + 8 * c) = o; }
    LDS_WAIT(); asm volatile("" ::: "memory");
}

__device__ __forceinline__ int rel_bucket(int rel) {
    const int ret = rel > 0 ? 16 : 0; const int n = rel < 0 ? -rel : rel;
    const float nf = (float)(n < 1 ? 1 : n);
    int large = 8 + (int)(logf(nf / 8.0f) / 4.852030263919617f * 8.0f);
    large = large < 15 ? large : 15;
    return ret + (n < 8 ? n : large);
}

struct Args {
    const float* x_prompt; const float* x_sample; const float* rel_bias; const float* w_qkv; const float* w_o_a; const float* w_o_b; const float* b_o_b;
    const float* w_gate; const float* w_up; const float* w_down; const float* ln1_g; const float* ln1_b; const float* ln2_g; const float* ln2_b;
    float* out; unsigned char* ws;
};

__device__ __forceinline__ void prologue(LAS unsigned char* lds, const Args& a, int G, int bid) {
    const int tid = opaque_tid(), lane = tid & 63, wave = tid >> 6;
    LAS float* scr = (LAS float*)(lds + wave * 16384);
    const int gw = bid * 8 + wave, NGW = G * 8;
    unsigned char* ws = a.ws;
    constexpr int I_QKV = 16 * 288, I_O = 16 * 32, I_G = 16 * 88, I_D = 44 * 32;
    constexpr int N_QKV = 2 * I_QKV, N_OA = 2 * I_O, N_OB = 2 * I_O, N_G = 4 * I_G, N_U = 4 * I_G, N_D = 4 * I_D;
    constexpr int NITEMS = N_QKV + N_OA + N_OB + N_G + N_U + N_D;
    for (int it = gw; it < NITEMS; it += NGW) {
        int r = it;
        if (r < N_QKV) { const int l = r / I_QKV, q = r % I_QKV, kb = q / 288, nb = q % 288;
            transpose_item(a.w_qkv + (size_t)l * DM * NQKV, DM, NQKV, (bf16_t*)(ws + WS_WQKV) + (size_t)l * NQKV * DM, 64 * kb, 32 * nb, 32 * nb, nb < 96 ? 0.125f : 1.0f, scr, lane); continue; }
        r -= N_QKV;
        if (r < N_OA) { const int l = r / I_O, q = r % I_O, kb = q / 32, nb = q % 32;
            transpose_item(a.w_o_a + (size_t)l * DM * DM, DM, DM, (bf16_t*)(ws + WS_WOA) + (size_t)l * DM * DM, 64 * kb, 32 * nb, 32 * nb, 1.0f, scr, lane); continue; }
        r -= N_OA;
        if (r < N_OB) { const int l = r / I_O, q = r % I_O, kb = q / 32, nb = q % 32;
            transpose_item(a.w_o_b + (size_t)l * DM * DM, DM, DM, (bf16_t*)(ws + WS_WOB) + (size_t)l * DM * DM, 64 * kb, 32 * nb, 32 * nb, 1.0f, scr, lane); continue; }
        r -= N_OB;
        if (r < N_G + N_U) { const int up = r >= N_G; if (up) r -= N_G; const int l = r / I_G, q = r % I_G, kb = q / 88, nb = q % 88; const int n0 = 32 * nb;
            transpose_item((up ? a.w_up : a.w_gate) + (size_t)l * DM * DFF, DM, DFF, (bf16_t*)(ws + WS_WGU) + (size_t)l * NGU * DM, 64 * kb, n0, (n0 >> 7) * 256 + (n0 & 127) + (up ? 128 : 0), 1.0f, scr, lane); continue; }
        r -= N_G + N_U;
        { const int l = r / I_D, q = r % I_D, kb = q / 32, nb = q % 32;
            transpose_item(a.w_down + (size_t)l * DFF * DM, DFF, DM, (bf16_t*)(ws + WS_WD) + (size_t)l * DM * DFF, 64 * kb, 32 * nb, 32 * nb, 1.0f, scr, lane); }
    }
    const int gt = bid * 512 + tid, NGT = G * 512;
    f32x2* tw = (f32x2*)(ws + WS_TW);
    for (int i = gt; i < 16384; i += NGT) { const float x = (float)i * (2.0f / 16384.0f); tw[i] = (f32x2){cospif(x), sinpif(x)}; }
    float* bt = (float*)(ws + WS_BIAS);
    for (int i = gt; i < 48 * 132; i += NGT) { const int gh = i / 132, idx = i % 132, g = gh >> 4; const int m = idx - 64;
        bt[i] = idx <= 128 ? a.rel_bias[rel_bucket(m << (2 * g)) * 48 + gh] : 0.f; }
    bf16_t* d128 = (bf16_t*)(ws + WS_DFT128);
    for (int i = gt; i < 2 * 128 * 128; i += NGT) { const int s = i >> 14, r = (i >> 7) & 127, c = i & 127; const float x = (float)((r * c) & 127) * (2.0f / 128.0f);
        d128[i] = (bf16_t)f2bf((s ? sinpif(x) : cospif(x)) * 0.08838834764831845f); }
    bf16_t* d64 = (bf16_t*)(ws + WS_DFT64);
    for (int i = gt; i < 2 * 64 * 64; i += NGT) { const int s = i >> 12, r = (i >> 6) & 63, c = i & 63; const float x = (float)((r * c) & 63) * (2.0f / 64.0f);
        d64[i] = (bf16_t)f2bf((s ? sinpif(x) : cospif(x)) * 0.125f); }
    bf16_t* wch = (bf16_t*)(ws + WS_WCH);
    for (int i = gt; i < 2048 * 256; i += NGT) { const int row = i >> 8, k = i & 255, n = row & 255, im = (row >> 8) & 1; const float x = (float)((k * n) & 255) * (2.0f / 256.0f);
        wch[i] = (bf16_t)f2bf((im ? -sinpif(x) : cospif(x)) * 0.0625f); }
}

__device__ __forceinline__ void convert_phase(const float* x, bf16_t* xb, int G, int bid) {
    const size_t n8 = (size_t)CH * DM / 8;
    const int tid = opaque_tid();
    for (size_t i = (size_t)bid * 512 + tid; i < n8; i += (size_t)G * 512) {
        const f32x4 a = *(const f32x4*)(x + i * 8), b = *(const f32x4*)(x + i * 8 + 4);
        u32x4 w; w.x = pk2(a[0], a[1]); w.y = pk2(a[2], a[3]); w.z = pk2(b[0], b[1]); w.w = pk2(b[2], b[3]);
        *(u32x4*)(xb + i * 8) = w; }
}

__device__ __forceinline__ float wave_sum(float v) {
#pragma unroll
    for (int o = 1; o < 64; o <<= 1) v += __shfl_xor(v, o);
    return v;
}
__device__ __forceinline__ void ln_phase(float* x, bf16_t* xb, const float* gam, const float* bet, int G, int bid) {
    const int tid = opaque_tid(); const int lane = tid & 63, wave = tid >> 6;
    f32x4 gv[4], bv[4];
#pragma unroll
    for (int j = 0; j < 4; ++j) { gv[j] = *(const f32x4*)(gam + 4 * lane + 256 * j); bv[j] = *(const f32x4*)(bet + 4 * lane + 256 * j); }
    for (int m = bid * 8 + wave; m < CH; m += G * 8) {
        f32x4* xr = (f32x4*)(x + (size_t)m * DM) + lane;
        f32x4 v[4]; float s = 0.f;
#pragma unroll
        for (int j = 0; j < 4; ++j) { v[j] = xr[64 * j]; s += (v[j].x + v[j].y) + (v[j].z + v[j].w); }
        const float mean = wave_sum(s) * (1.f / DM); float s2 = 0.f;
#pragma unroll
        for (int j = 0; j < 4; ++j) { v[j] = v[j] - mean; s2 += (v[j].x * v[j].x + v[j].y * v[j].y) + (v[j].z * v[j].z + v[j].w * v[j].w); }
        const float rstd = 1.f / sqrtf(wave_sum(s2) * (1.f / DM) + LN_EPS);
        u32x2* o8 = (u32x2*)(xb + (size_t)m * DM) + lane;
#pragma unroll
        for (int j = 0; j < 4; ++j) { const f32x4 y = v[j] * rstd * gv[j] + bv[j]; xr[64 * j] = y; o8[64 * j] = (u32x2){pk2(y.x, y.y), pk2(y.z, y.w)}; }
    }
}

constexpr int AT_OBUF = 0, AT_M = 65536, AT_D = 66560, AT_BT = 67584, AT_V = 69632, AT_VPITCH = 160, AT_VBYTES = 32 * AT_VPITCH;
__device__ __forceinline__ unsigned obuf_off(int pos, int chunk) { return (unsigned)pos * 256u + (unsigned)((chunk ^ (pos ^ (pos >> 4))) & 15) * 16u; }

__device__ __forceinline__ void attn_phase(LAS unsigned char* lds, const bf16_t* qkv, bf16_t* o, const float* biasT, int S, int G, int bid) {
    const int tid = opaque_tid(), lane = tid & 63, wave = __builtin_amdgcn_readfirstlane(tid >> 6);
    const int l15 = lane & 15, lg = lane >> 4;
    LAS float* BT = (LAS float*)(lds + AT_BT);
    LAS float* MB = (LAS float*)(lds + AT_M);
    LAS float* DB = (LAS float*)(lds + AT_D);
    LAS unsigned char* vbuf = lds + AT_V + wave * AT_VBYTES;
    const int nunits = (CH / 256) * 16;
    for (int u = bid; u < nunits; u += G) {
        const int h = u & 15, pb = u >> 4;
        const int row0 = pb * 256, seq0 = (row0 / S) * S, P0 = row0 - seq0;
        __syncthreads();
        if (tid < 3 * 132) { const int g = tid / 132, idx = tid - g * 132; BT[tid] = biasT[(g * 16 + h) * 132 + idx]; }
        __syncthreads();
        for (int g = 0; g < 3; ++g) {
            const int sh = 2 * g, r = 1 << sh, L = S >> sh;
            const bf16_t* qb = qkv + (size_t)seq0 * NQKV + g * 1024 + h * 64;
            for (int tk = wave; tk < 16; tk += 8) {
                const int c = tk & (r - 1), jb = tk >> sh;
                const int jq0 = (P0 >> sh) + 16 * jb;
                const int posq = ((jq0 + l15) << sh) + c;
                const bf16_t* qp = qb + (size_t)posq * NQKV + 8 * lg;
                const bf16x8 qf0 = *(const bf16x8*)qp, qf1 = *(const bf16x8*)(qp + 32);
                f32x4 s[9];
#pragma unroll
                for (int kt = 0; kt < 9; ++kt) {
                    int jk = jq0 - 64 + 16 * kt + l15; jk = jk < 0 ? 0 : (jk > L - 1 ? L - 1 : jk);
                    const bf16_t* kp = qb + (size_t)((jk << sh) + c) * NQKV + 3072 + 8 * lg;
                    const bf16x8 kf0 = *(const bf16x8*)kp, kf1 = *(const bf16x8*)(kp + 32);
                    f32x4 z = (f32x4){0.f, 0.f, 0.f, 0.f};
                    z = __builtin_amdgcn_mfma_f32_16x16x32_bf16(kf0, qf0, z, 0, 0, 0);
                    s[kt] = __builtin_amdgcn_mfma_f32_16x16x32_bf16(kf1, qf1, z, 0, 0, 0);
                }
                float mx = -3.0e38f;
#pragma unroll
                for (int kt = 0; kt < 9; ++kt)
#pragma unroll
                    for (int i = 0; i < 4; ++i) {
                        const int kr = 16 * kt + 4 * lg + i;
                        const int idx = kr - l15;
                        const int jk = jq0 - 64 + kr;
                        const bool ok = (idx >= 0) && (idx <= 128) && (jk >= 0) && (jk < L);
                        const int ic = idx < 0 ? 0 : (idx > 128 ? 128 : idx);
                        const float v = ok ? s[kt][i] + BT[g * 132 + ic] : -1.0e30f;
                        s[kt][i] = v; mx = fmaxf(mx, v);
                    }
                mx = fmaxf(mx, __shfl_xor(mx, 16)); mx = fmaxf(mx, __shfl_xor(mx, 32));
                float den = 0.f;
#pragma unroll
                for (int kt = 0; kt < 9; ++kt)
#pragma unroll
                    for (int i = 0; i < 4; ++i) { const float p = __expf(s[kt][i] - mx); s[kt][i] = p; den += p; }
                den += __shfl_xor(den, 16); den += __shfl_xor(den, 32);
                f32x4 oacc[4];
#pragma unroll
                for (int dt = 0; dt < 4; ++dt) oacc[dt] = (f32x4){0.f, 0.f, 0.f, 0.f};
                const bf16_t* vb = qb + 6144 + 8 * (lane & 7);
                u32x4 vr[4];
#pragma unroll
                for (int it = 0; it < 4; ++it) { int jk = jq0 - 64 + (lane >> 3) + 8 * it; jk = jk < 0 ? 0 : (jk > L - 1 ? L - 1 : jk);
                    vr[it] = *(const u32x4*)(vb + (size_t)((jk << sh) + c) * NQKV); }
#pragma unroll
                for (int st = 0; st < 5; ++st) {
#pragma unroll
                    for (int it = 0; it < 4; ++it) *(LAS u32x4*)(vbuf + ((lane >> 3) + 8 * it) * AT_VPITCH + (lane & 7) * 16) = vr[it];
                    if (st < 4) {
#pragma unroll
                        for (int it = 0; it < 4; ++it) { int jk = jq0 - 64 + 32 * (st + 1) + (lane >> 3) + 8 * it; jk = jk < 0 ? 0 : (jk > L - 1 ? L - 1 : jk);
                            vr[it] = *(const u32x4*)(vb + (size_t)((jk << sh) + c) * NQKV); }
                    }
                    u32x4 pw;
                    pw.x = cvt_pk_bf16(s[2 * st][0], s[2 * st][1]); pw.y = cvt_pk_bf16(s[2 * st][2], s[2 * st][3]);
                    if (st < 4) { pw.z = cvt_pk_bf16(s[2 * st + 1 < 9 ? 2 * st + 1 : 8][0], s[2 * st + 1 < 9 ? 2 * st + 1 : 8][1]); pw.w = cvt_pk_bf16(s[2 * st + 1 < 9 ? 2 * st + 1 : 8][2], s[2 * st + 1 < 9 ? 2 * st + 1 : 8][3]); }
                    else { pw.z = 0u; pw.w = 0u; }
                    const bf16x8 pf = __builtin_bit_cast(bf16x8, pw);
#pragma unroll
                    for (int dt = 0; dt < 4; ++dt) {
                        const unsigned ad = (unsigned)((4 * lg + (l15 >> 2)) * AT_VPITCH + (16 * dt + 4 * (lane & 3)) * 2);
                        const s16x4 lo = __builtin_amdgcn_ds_read_tr16_b64_v4i16((LAS s16x4*)(vbuf + ad));
                        const s16x4 hi = __builtin_amdgcn_ds_read_tr16_b64_v4i16((LAS s16x4*)(vbuf + ad + 16 * AT_VPITCH));
                        const bf16x8 vf = __builtin_shufflevector(lo, hi, 0, 1, 2, 3, 4, 5, 6, 7);
                        oacc[dt] = __builtin_amdgcn_mfma_f32_16x16x32_bf16(vf, pf, oacc[dt], 0, 0, 0);
                    }
                }
                const int pl = c + ((16 * jb + l15) << sh);
                if (g == 0) {
#pragma unroll
                    for (int dt = 0; dt < 4; ++dt) *(LAS f32x4*)(lds + AT_OBUF + obuf_off(pl, 4 * dt + lg)) = oacc[dt];
                    if (lg == 0) { MB[pl] = mx; DB[pl] = den; }
                } else {
                    const float mo = MB[pl], dold = DB[pl];
                    const float mn = fmaxf(mo, mx), fa = __expf(mo - mn), fb = __expf(mx - mn);
                    const float dn = dold * fa + den * fb;
                    if (g == 1) {
#pragma unroll
                        for (int dt = 0; dt < 4; ++dt) { LAS f32x4* p = (LAS f32x4*)(lds + AT_OBUF + obuf_off(pl, 4 * dt + lg)); *p = *p * fa + oacc[dt] * fb; }
                        if (lg == 0) { MB[pl] = mn; DB[pl] = dn; }
                    } else {
                        const float inv = 1.0f / dn;
                        bf16_t* op = o + (size_t)(row0 + pl) * DM + h * 64 + 4 * lg;
#pragma unroll
                        for (int dt = 0; dt < 4; ++dt) { const f32x4 t = (*(LAS f32x4*)(lds + AT_OBUF + obuf_off(pl, 4 * dt + lg)) * fa + oacc[dt] * fb) * inv;
                            *(u32x2*)(op + 16 * dt) = (u32x2){cvt_pk_bf16(t[0], t[1]), cvt_pk_bf16(t[2], t[3])}; }
                    }
                }
            }
            __syncthreads();
        }
    }
}

template <int STAGE, int N>
__device__ __forceinline__ void dft_phase(LAS unsigned char* lds, const bf16_t* X, bf16_t* Yout, const bf16_t* tab, const f32x2* tw, int G, int bid) {
    constexpr int NMT = N / 32, NKS = N / 16, PITCH = 2 * N + 16, S = N * N, NSEQ = CH / S;
    const int tid = opaque_tid(), lane = tid & 63, wave = __builtin_amdgcn_readfirstlane(tid >> 6);
    const int l31 = lane & 31, lh = lane >> 5;
    __syncthreads();
    for (int i = tid; i < 2 * N * N / 8; i += 512) { const int s = i / (N * N / 8), rem = i % (N * N / 8), r = rem / (N / 8), c8 = rem % (N / 8);
        *(LAS u32x4*)(lds + (s * N + r) * PITCH + c8 * 16) = *(const u32x4*)(tab + (size_t)s * N * N + r * N + c8 * 8); }
    __syncthreads();
    const int ntiles = NSEQ * N * 4;
    for (int t = bid; t < ntiles; t += G) {
        const int g = t & 3, f = (t >> 2) % N, seq = (t >> 2) / N;
        const int colr = 512 * g + 32 * wave + l31;
        const bf16_t* xb = X + (size_t)seq * S * 2048 + colr;
        f32x16 are[NMT], aim[STAGE == 1 ? NMT : 1];
#pragma unroll
        for (int mt = 0; mt < NMT; ++mt) {
#pragma unroll
            for (int i = 0; i < 16; ++i) { are[mt][i] = 0.f; if (STAGE == 1) aim[mt][i] = 0.f; } }
#pragma unroll 2
        for (int ks = 0; ks < NKS; ++ks) {
            u32x4 wre, wim;
#pragma unroll
            for (int j2 = 0; j2 < 4; ++j2) {
                const int k0 = 16 * ks + 8 * lh + 2 * j2;
                const size_t r0 = (STAGE == 1) ? (size_t)(N * k0 + f) : (size_t)(N * f + k0);
                const size_t r1 = (STAGE == 1) ? r0 + N : r0 + 1;
                const unsigned a0 = xb[r0 * 2048], a1 = xb[r1 * 2048], b0 = xb[r0 * 2048 + 256], b1 = xb[r1 * 2048 + 256];
                wre[j2] = a0 | (a1 << 16); wim[j2] = b0 | (b1 << 16);
            }
            const bf16x8 fre = __builtin_bit_cast(bf16x8, wre), fim = __builtin_bit_cast(bf16x8, wim);
            u32x4 wn = wre; wn.x ^= 0x80008000u; wn.y ^= 0x80008000u; wn.z ^= 0x80008000u; wn.w ^= 0x80008000u;
            const bf16x8 fnre = __builtin_bit_cast(bf16x8, wn);
#pragma unroll
            for (int mt = 0; mt < NMT; ++mt) {
                const bf16x8 ca = *(const LAS bf16x8*)(lds + (32 * mt + l31) * PITCH + (16 * ks + 8 * lh) * 2);
                const bf16x8 sa = *(const LAS bf16x8*)(lds + (N + 32 * mt + l31) * PITCH + (16 * ks + 8 * lh) * 2);
                are[mt] = __builtin_amdgcn_mfma_f32_32x32x16_bf16(ca, fre, are[mt], 0, 0, 0);
                are[mt] = __builtin_amdgcn_mfma_f32_32x32x16_bf16(sa, fim, are[mt], 0, 0, 0);
                if (STAGE == 1) {
                    aim[mt] = __builtin_amdgcn_mfma_f32_32x32x16_bf16(ca, fim, aim[mt], 0, 0, 0);
                    aim[mt] = __builtin_amdgcn_mfma_f32_32x32x16_bf16(sa, fnre, aim[mt], 0, 0, 0);
                }
            }
        }
        if (STAGE == 1) {
            bf16_t* yo = Yout + (size_t)seq * S * 2048 + colr;
#pragma unroll
            for (int mt = 0; mt < NMT; ++mt)
#pragma unroll
                for (int i = 0; i < 16; ++i) {
                    const int k1 = 32 * mt + (i & 3) + 8 * (i >> 2) + 4 * lh;
                    const f32x2 w = tw[(k1 * f) * (16384 / S)];
                    const float re = are[mt][i], im = aim[mt][i];
                    const float orr = re * w.x + im * w.y, oi = im * w.x - re * w.y;
                    const size_t ro = (size_t)(N * k1 + f) * 2048;
                    yo[ro] = (bf16_t)f2bf(orr); yo[ro + 256] = (bf16_t)f2bf(oi);
                }
        } else {
            bf16_t* yo = Yout + (size_t)seq * S * 1024 + 256 * g + 32 * wave + l31;
#pragma unroll
            for (int mt = 0; mt < NMT; ++mt)
#pragma unroll
                for (int i = 0; i < 16; ++i) {
                    const int k2 = 32 * mt + (i & 3) + 8 * (i >> 2) + 4 * lh;
                    yo[(size_t)(f + N * k2) * 1024] = (bf16_t)f2bf(are[mt][i]);
                }
        }
    }
    __syncthreads();
}


#define XB_TMO      128
#define XB_XCNT(j)  (256  + 64 * (j))
#define XB_XSUB(j)  (1280 + 64 * (j))
#define XB_XGEN(j)  (2304 + 64 * (j))
#define XB_TOP      3328
#define XB_TOPGEN   3392
#define XCD_BAR_WORDS 3456
#define XB_SPIN_CAP (1u << 22)
__device__ __forceinline__ unsigned xb_ld(unsigned* p)              { return __hip_atomic_load(p, __ATOMIC_RELAXED, __HIP_MEMORY_SCOPE_AGENT); }
__device__ __forceinline__ unsigned xb_add(unsigned* p, unsigned v) { return __hip_atomic_fetch_add(p, v, __ATOMIC_RELAXED, __HIP_MEMORY_SCOPE_AGENT); }
__device__ __forceinline__ unsigned xb_xcc_id() { return (unsigned)__builtin_amdgcn_s_getreg((3 << 11) | 20) & 0xFu; }
#define XB_SPIN(cond, bar) do { unsigned _sp = 0; while (cond) { __builtin_amdgcn_s_sleep(1); \
    if ((++_sp & 255u) == 0u) { if (xb_ld(&(bar)[XB_TMO])) break; if (_sp > XB_SPIN_CAP) { atomicAdd(&(bar)[XB_TMO], 1u); break; } } } } while (0)
struct XcdBarrier { unsigned* bar; unsigned x; volatile LAS unsigned* st; };
__device__ __forceinline__ XcdBarrier xcd_barrier_post(unsigned* bar, volatile LAS unsigned* st) {
    XcdBarrier b; b.bar = bar; b.x = xb_xcc_id(); b.st = st;
    if (threadIdx.x == 0) (void)xb_add(&bar[XB_XCNT(b.x)], 1u);
    return b;
}
__device__ __forceinline__ void xcd_barrier_complete(unsigned* bar, unsigned x, unsigned& nloc, unsigned& nx) {
    const unsigned G = gridDim.x * gridDim.y * gridDim.z;
    unsigned sum, cnt, mine, sp = 0u;
    for (;;) {
        sum = 0u; cnt = 0u; mine = 0u;
#pragma unroll
        for (unsigned j = 0; j < 16; ++j) { const unsigned c = xb_ld(&bar[XB_XCNT(j)]); sum += c; cnt += (c > 0u) ? 1u : 0u; mine = (j == x) ? c : mine; }
        if (sum == G) break;
        __builtin_amdgcn_s_sleep(1);
        if ((++sp & 255u) == 0u) { if (xb_ld(&bar[XB_TMO])) break; if (sp > XB_SPIN_CAP) { atomicAdd(&bar[XB_TMO], 1u); break; } }
    }
    nloc = mine > 0u ? mine : 1u; nx = cnt > 0u ? cnt : 1u;
}
__device__ __forceinline__ void xcd_barrier(const XcdBarrier& b) {
    asm volatile("s_waitcnt vmcnt(0)" ::: "memory");
    __syncthreads();
    if (threadIdx.x == 0) {
        unsigned* bar = b.bar;
        __builtin_amdgcn_s_waitcnt(0);
        unsigned nloc = b.st[0], nx = b.st[1];
        if (nloc == 0u) { xcd_barrier_complete(bar, b.x, nloc, nx); b.st[0] = nloc; b.st[1] = nx; }
        const unsigned old = xb_add(&bar[XB_XSUB(b.x)], 1u);
        const unsigned gen = old / nloc;
        if (old + 1u == (gen + 1u) * nloc) {
            __builtin_amdgcn_fence(__ATOMIC_RELEASE, "agent");
            asm volatile("s_waitcnt vmcnt(0)" ::: "memory");
            const unsigned og = xb_add(&bar[XB_TOP], 1u);
            const unsigned tg = og / nx;
            if (og + 1u == (tg + 1u) * nx) xb_add(&bar[XB_TOPGEN], 1u);
            else XB_SPIN(xb_ld(&bar[XB_TOPGEN]) == tg, bar);
            __builtin_amdgcn_fence(__ATOMIC_ACQUIRE, "agent");
            xb_add(&bar[XB_XGEN(b.x)], 1u);
            asm volatile("s_waitcnt vmcnt(0)" ::: "memory");
        } else {
            XB_SPIN(xb_ld(&bar[XB_XGEN(b.x)]) == gen, bar);
            __builtin_amdgcn_fence(__ATOMIC_ACQUIRE, "agent");
            asm volatile("s_waitcnt vmcnt(0)" ::: "memory");
        }
    }
    __syncthreads();
}

#define GRID_SYNC() do { xcd_barrier(bar); __builtin_amdgcn_fence(__ATOMIC_ACQUIRE, "agent"); asm volatile("s_waitcnt vmcnt(0)" ::: "memory"); } while (0)
__global__ void __launch_bounds__(512, 2) fwd_megakernel(Args a) {
    extern __shared__ __attribute__((aligned(16))) unsigned char lds_raw[];
    LAS unsigned char* lds = (LAS unsigned char*)lds_raw;
    cg::grid_group grid = cg::this_grid();
    const int G = gridDim.x, bid = blockIdx.x;
    unsigned char* ws = a.ws;
    bf16_t* XB = (bf16_t*)(ws + WS_XB); bf16_t* OB = (bf16_t*)(ws + WS_O);
    bf16_t* QKV = (bf16_t*)(ws + WS_BIG); bf16_t* ZB = (bf16_t*)(ws + WS_BIG + BIG_Z); bf16_t* GB = (bf16_t*)(ws + WS_BIG + BIG_G); bf16_t* ACT = (bf16_t*)(ws + WS_BIG + BIG_ACT);

    volatile LAS unsigned* MISC = (volatile LAS unsigned*)(lds + LDS_MISC);
    if (threadIdx.x < 32) MISC[threadIdx.x] = 0u;
    __syncthreads();
    XcdBarrier bar = xcd_barrier_post((unsigned*)ws, MISC + 8);
    grid.sync();
    prologue(lds, a, G, bid);
    for (int ch = 0; ch < NCHUNK; ++ch) {
        const float* xin = (ch < 2) ? a.x_prompt + (size_t)ch * CH * DM : a.x_sample + (size_t)(ch - 2) * CH * DM;
        float* xo = a.out + (size_t)ch * CH * DM;
        const int S = (ch < 2) ? 16384 : 4096;
        convert_phase(xin, XB, G, bid);
        GRID_SYNC();
        for (int layer = 0; layer < DEPTH; ++layer) {
            const int li = layer >> 1;
            const float* res = (layer == 0) ? xin : xo;
            if ((layer & 1) == 0) {
                { pg8::Gemm g{XB, (const bf16_t*)(ws + WS_WQKV) + (size_t)li * NQKV * DM, CH, NQKV, DM, DM, DM, 0, 0}; pg8::StaticOrder So; So.init(CH, NQKV, G, bid);
                  pg8::EpiBf16 E{QKV, NQKV}; pg8::gemm_phase<pg8::EpiBf16>(lds, g, So, E); }
                GRID_SYNC();
                if (!DBG_SKIP_ATTN) attn_phase(lds, QKV, OB, (const float*)(ws + WS_BIAS), S, G, bid);
                GRID_SYNC();
                { pg8::Gemm g{DBG_SKIP_ATTN ? XB : OB, (const bf16_t*)(ws + WS_WOA) + (size_t)li * DM * DM, CH, DM, DM, DM, DM, 0, 0}; pg8::StaticOrder So; So.init(CH, DM, G, bid);
                  pg8::EpiRes E{res, xo, nullptr}; pg8::gemm_phase<pg8::EpiRes>(lds, g, So, E); }
                GRID_SYNC();
            } else {
                { pg8::Gemm g{XB, (const bf16_t*)(ws + WS_WCH), CH, 2048, 256, DM, 256, 1, 256}; pg8::StaticOrder So; So.init(CH, 2048, G, bid);
                  pg8::EpiBf16 E{ZB, 2048}; pg8::gemm_phase<pg8::EpiBf16>(lds, g, So, E); }
                GRID_SYNC();
                if (DBG_SKIP_DFT) {} else if (ch < 2) dft_phase<1, 128>(lds, ZB, GB, (const bf16_t*)(ws + WS_DFT128), (const f32x2*)(ws + WS_TW), G, bid);
                else        dft_phase<1, 64>(lds, ZB, GB, (const bf16_t*)(ws + WS_DFT64), (const f32x2*)(ws + WS_TW), G, bid);
                GRID_SYNC();
                if (DBG_SKIP_DFT) {} else if (ch < 2) dft_phase<2, 128>(lds, GB, OB, (const bf16_t*)(ws + WS_DFT128), (const f32x2*)(ws + WS_TW), G, bid);
                else        dft_phase<2, 64>(lds, GB, OB, (const bf16_t*)(ws + WS_DFT64), (const f32x2*)(ws + WS_TW), G, bid);
                GRID_SYNC();
                { pg8::Gemm g{DBG_SKIP_DFT ? XB : OB, (const bf16_t*)(ws + WS_WOB) + (size_t)li * DM * DM, CH, DM, DM, DM, DM, 0, 0}; pg8::StaticOrder So; So.init(CH, DM, G, bid);
                  pg8::EpiRes E{res, xo, a.b_o_b + (size_t)li * DM}; pg8::gemm_phase<pg8::EpiRes>(lds, g, So, E); }
                GRID_SYNC();
            }
            ln_phase(xo, XB, a.ln1_g + layer * DM, a.ln1_b + layer * DM, G, bid);
            GRID_SYNC();
            { pg8::Gemm g{XB, (const bf16_t*)(ws + WS_WGU) + (size_t)layer * NGU * DM, CH, NGU, DM, DM, DM, 0, 0}; pg8::StaticOrder So; So.init(CH, NGU, G, bid);
              pg8::EpiGU E{ACT}; pg8::gemm_phase<pg8::EpiGU>(lds, g, So, E); }
            GRID_SYNC();
            { pg8::Gemm g{ACT, (const bf16_t*)(ws + WS_WD) + (size_t)layer * DM * DFF, CH, DM, DFF, DFF, DFF, 0, 0}; pg8::StaticOrder So; So.init(CH, DM, G, bid);
              pg8::EpiRes E{xo, xo, nullptr}; pg8::gemm_phase<pg8::EpiRes>(lds, g, So, E); }
            GRID_SYNC();
            ln_phase(xo, XB, a.ln2_g + layer * DM, a.ln2_b + layer * DM, G, bid);
            GRID_SYNC();
        }
    }
}

extern "C" void kernel_launch(void* const* d_in, const int* in_sizes, int n_in, void* d_out, int out_size, void* d_ws, size_t ws_size, hipStream_t stream) {
    static int grid = 0;
    if (grid == 0) {
        if (n_in != 14 || ws_size < WS_END) { fprintf(stderr, "kernel_launch: unexpected inputs (n_in %d, ws %zu < %zu)\n", n_in, ws_size, (size_t)WS_END); grid = -1; return; }
        int dev = 0, cus = 0, per_cu = 0;
        hipGetDevice(&dev);
        hipDeviceGetAttribute(&cus, hipDeviceAttributeMultiprocessorCount, dev);
        if (hipFuncSetAttribute((const void*)fwd_megakernel, hipFuncAttributeMaxDynamicSharedMemorySize, LDS_BYTES) != hipSuccess) { fprintf(stderr, "kernel_launch: hipFuncSetAttribute failed\n"); grid = -1; return; }
        if (hipOccupancyMaxActiveBlocksPerMultiprocessor(&per_cu, (const void*)fwd_megakernel, 512, LDS_BYTES) != hipSuccess || per_cu < 1) { fprintf(stderr, "kernel_launch: occupancy query gave %d\n", per_cu); per_cu = 1; }
        (void)hipGetLastError();
        grid = cus * 1;
        fprintf(stderr, "kernel_launch: grid %d (per_cu %d)\n", grid, per_cu);
    }
    if (grid < 0) return;
    Args a{};
    a.x_prompt = (const float*)d_in[0]; a.x_sample = (const float*)d_in[1]; a.rel_bias = (const float*)d_in[2]; a.w_qkv = (const float*)d_in[3];
    a.w_o_a = (const float*)d_in[4]; a.w_o_b = (const float*)d_in[5]; a.b_o_b = (const float*)d_in[6]; a.w_gate = (const float*)d_in[7];
    a.w_up = (const float*)d_in[8]; a.w_down = (const float*)d_in[9]; a.ln1_g = (const float*)d_in[10]; a.ln1_b = (const float*)d_in[11];
    a.ln2_g = (const float*)d_in[12]; a.ln2_b = (const float*)d_in[13];
    a.out = (float*)d_out; a.ws = (unsigned char*)d_ws;
    if (hipMemsetAsync(d_ws, 0, 65536, stream) != hipSuccess) { fprintf(stderr, "kernel_launch: memset failed\n"); return; }
    void* args[] = {&a};
    hipError_t e = hipLaunchCooperativeKernel((const void*)fwd_megakernel, dim3(grid), dim3(512), args, LDS_BYTES, stream);
    if (e != hipSuccess) fprintf(stderr, "cooperative launch failed: %s (grid %d)\n", hipGetErrorString(e), grid);
}
```
